# Optimizing an MI355X kernel written in HIP

```python
import jax, jax.numpy as jnp
from jax import lax
import numpy as np

D_MODEL = 1024
BATCH = 8
SEQ = 2048
DEPTH = 2
DEC_BATCH = 128
DEC_SEQ = 1
PAST_LEN = 16384
PAGE_SIZE = 128

MIX_WIDTH = D_MODEL
A_WIDTH = 3 * MIX_WIDTH // 8
A_HEADS = 4
A_HEAD_DIM = A_WIDTH // A_HEADS
CHUNK = 128
B_WIDTH = 3 * MIX_WIDTH // 8
B_BLOCKS = 8
B_BLOCK_DIM = B_WIDTH // B_BLOCKS
CONV_WIDTH = 4
LRU_C = 8.0
C_WIDTH = MIX_WIDTH - A_WIDTH - B_WIDTH
C_HEADS = 4
C_HEAD_DIM = C_WIDTH // C_HEADS
N_MEM = 256
IN_WIDTH = 3 * A_WIDTH + 2 * B_WIDTH + 2 * C_WIDTH
EPS = 1e-6

kernel_name = "hymba_gmlp_rglru_memxattn_step"


def rmsnorm(x, g):
    xf = x.astype(jnp.float32)
    y = xf * lax.rsqrt(jnp.mean(xf * xf, axis=-1, keepdims=True) + EPS)
    return (y * g.astype(jnp.float32)).astype(x.dtype)


def chunk_spatial_gate(u, v, w_s, b_s):
    n, t, h, dh = v.shape
    t_pad = -(-t // CHUNK) * CHUNK
    if t_pad != t:
        v = jnp.pad(v, ((0, 0), (0, t_pad - t), (0, 0), (0, 0)))
    vc = v.reshape(n, t_pad // CHUNK, CHUNK, h, dh)
    mask = jnp.tril(jnp.ones((CHUNK, CHUNK), dtype=bool))
    ws = jnp.where(mask[None], w_s, jnp.zeros_like(w_s))
    mixed = jnp.einsum('hij,ncjhd->ncihd', ws, vc) + b_s.T[:, :, None]
    mixed = mixed.reshape(n, t_pad, h, dh)[:, :t]
    return u * mixed


def causal_conv(xb, buf, w, b):
    t = xb.shape[1]
    xp = jnp.concatenate([buf.astype(xb.dtype), xb], axis=1)
    out = b
    for k in range(CONV_WIDTH):
        out = out + xp[:, k:k + t] * w[k]
    return out, xp[:, -(CONV_WIDTH - 1):]


def rg_lru(xc, h0, w_a, b_a, w_x, b_x, lam):
    n, t, _ = xc.shape
    xf = xc.astype(jnp.float32)
    xblk = xf.reshape(n, t, B_BLOCKS, B_BLOCK_DIM)
    r = jax.nn.sigmoid(jnp.einsum('ntki,kij->ntkj', xblk, w_a.astype(jnp.float32)).reshape(n, t, B_WIDTH) + b_a.astype(jnp.float32))
    i = jax.nn.sigmoid(jnp.einsum('ntki,kij->ntkj', xblk, w_x.astype(jnp.float32)).reshape(n, t, B_WIDTH) + b_x.astype(jnp.float32))
    log_a = -LRU_C * r * jax.nn.softplus(-lam.astype(jnp.float32))
    a = jnp.exp(log_a)
    inp = jnp.sqrt(-jnp.expm1(2.0 * log_a)) * (i * xf)

    def step(h, elems):
        a_t, x_t = elems
        h = a_t * h + x_t
        return h, h

    h_last, hs = lax.scan(step, h0.astype(jnp.float32), (a.transpose(1, 0, 2), inp.transpose(1, 0, 2)))
    return hs.transpose(1, 0, 2).astype(xc.dtype), h_last.astype(h0.dtype)


def mem_kv(mem, g_mem, w_mk, w_mv):
    n = mem.shape[0]
    m = rmsnorm(mem, g_mem)
    k = (m @ w_mk).reshape(n, N_MEM, C_HEADS, C_HEAD_DIM)
    v = (m @ w_mv).reshape(n, N_MEM, C_HEADS, C_HEAD_DIM)
    return k, v


def cross_attend(q, k, v):
    n, t, _ = q.shape
    q = q.reshape(n, t, C_HEADS, C_HEAD_DIM)
    s = jnp.einsum('nthd,nshd->nhts', q, k.astype(q.dtype)).astype(jnp.float32) * (C_HEAD_DIM ** -0.5)
    p = jax.nn.softmax(s, axis=-1).astype(q.dtype)
    o = jnp.einsum('nhts,nshd->nthd', p, v.astype(q.dtype))
    return o.reshape(n, t, C_WIDTH)


def mixer_layer(x, mk, mv, conv_buf, h0, g_pre, g_post, w_in, w_out, g_v, w_s, b_s,
                w_conv, b_conv, w_a, b_a, w_x, b_x, lam):
    n, t, _ = x.shape
    h = rmsnorm(x, g_pre)
    z = h @ w_in
    cuts = [A_WIDTH, 2 * A_WIDTH, 3 * A_WIDTH, 3 * A_WIDTH + B_WIDTH,
            3 * A_WIDTH + 2 * B_WIDTH, 3 * A_WIDTH + 2 * B_WIDTH + C_WIDTH]
    u, v, ga, xb, gb, q, gc = jnp.split(z, cuts, axis=-1)
    vn = rmsnorm(v.reshape(n, t, A_HEADS, A_HEAD_DIM), g_v.reshape(A_HEADS, A_HEAD_DIM))
    out_a = chunk_spatial_gate(u.reshape(n, t, A_HEADS, A_HEAD_DIM), vn, w_s, b_s).reshape(n, t, A_WIDTH)
    out_a = out_a * jax.nn.silu(ga)
    xc, new_buf = causal_conv(xb, conv_buf, w_conv, b_conv)
    hs, h_last = rg_lru(xc, h0, w_a, b_a, w_x, b_x, lam)
    out_b = hs * jax.nn.silu(gb)
    out_c = cross_attend(q, mk, mv) * jax.nn.silu(gc)
    o = jnp.concatenate([out_a, out_b, out_c], axis=-1) @ w_out
    y = x + rmsnorm(o, g_post)
    return y, vn.reshape(n, t, A_WIDTH), new_buf, h_last


def setup_inputs(seed: int = 0) -> dict:
    key = jax.random.key(seed)
    ks = jax.random.split(key, 32)
    f32 = jnp.float32
    nrm = lambda k, s, sc: jax.random.normal(k, s, f32) * sc
    a_init = jax.random.uniform(ks[20], (DEPTH, B_WIDTH), f32, 0.9, 0.999)
    return {
        "x_prompt": nrm(ks[0], (BATCH, SEQ, D_MODEL), 1.0),
        "x_sample": nrm(ks[1], (DEC_BATCH, DEC_SEQ, D_MODEL), 1.0),
        "mem_prompt": nrm(ks[2], (BATCH, N_MEM, D_MODEL), 1.0),
        "cache_mem_k": nrm(ks[3], (DEPTH, DEC_BATCH, N_MEM, C_HEADS, C_HEAD_DIM), 1.0),
        "cache_mem_v": nrm(ks[4], (DEPTH, DEC_BATCH, N_MEM, C_HEADS, C_HEAD_DIM), 1.0),
        "state_conv": nrm(ks[5], (DEPTH, DEC_BATCH, CONV_WIDTH - 1, B_WIDTH), 1.0),
        "state_h": nrm(ks[6], (DEPTH, DEC_BATCH, B_WIDTH), 0.5),
        "g_pre": 1.0 + nrm(ks[7], (DEPTH, D_MODEL), 0.02),
        "g_post": 1.0 + nrm(ks[8], (DEPTH, D_MODEL), 0.02),
        "w_in": nrm(ks[9], (DEPTH, D_MODEL, IN_WIDTH), D_MODEL ** -0.5),
        "w_out": nrm(ks[10], (DEPTH, MIX_WIDTH, D_MODEL), MIX_WIDTH ** -0.5),
        "g_v": 1.0 + nrm(ks[11], (DEPTH, A_WIDTH), 0.02),
        "w_s": nrm(ks[12], (DEPTH, A_HEADS, CHUNK, CHUNK), CHUNK ** -0.5),
        "b_s": 1.0 + nrm(ks[13], (DEPTH, A_HEADS, CHUNK), 0.02),
        "w_conv": nrm(ks[14], (DEPTH, CONV_WIDTH, B_WIDTH), CONV_WIDTH ** -0.5),
        "b_conv": nrm(ks[15], (DEPTH, B_WIDTH), 0.01),
        "w_a": nrm(ks[16], (DEPTH, B_BLOCKS, B_BLOCK_DIM, B_BLOCK_DIM), B_BLOCK_DIM ** -0.5),
        "b_a": nrm(ks[17], (DEPTH, B_WIDTH), 0.01),
        "w_x": nrm(ks[18], (DEPTH, B_BLOCKS, B_BLOCK_DIM, B_BLOCK_DIM), B_BLOCK_DIM ** -0.5),
        "b_x": nrm(ks[19], (DEPTH, B_WIDTH), 0.01),
        "lru_lambda": jnp.log(a_init) - jnp.log1p(-a_init),
        "g_mem": 1.0 + nrm(ks[21], (DEPTH, D_MODEL), 0.02),
        "w_mk": nrm(ks[22], (DEPTH, D_MODEL, C_WIDTH), D_MODEL ** -0.5),
        "w_mv": nrm(ks[23], (DEPTH, D_MODEL, C_WIDTH), D_MODEL ** -0.5),
    }


def reference(x_prompt, x_sample, mem_prompt, cache_mem_k, cache_mem_v, state_conv, state_h,
              g_pre, g_post, w_in, w_out, g_v, w_s, b_s, w_conv, b_conv, w_a, b_a, w_x, b_x,
              lru_lambda, g_mem, w_mk, w_mv):
    xp, xs = x_prompt, x_sample
    zero_buf = jnp.zeros((x_prompt.shape[0], CONV_WIDTH - 1, B_WIDTH), x_prompt.dtype)
    zero_h = jnp.zeros((x_prompt.shape[0], B_WIDTH), x_prompt.dtype)
    mk_p_all, mv_p_all, conv_p_all, h_p_all = [], [], [], []
    conv_s_all, h_s_all, v_s_all = [], [], []
    for l in range(DEPTH):
        lp = (g_pre[l], g_post[l], w_in[l], w_out[l], g_v[l], w_s[l], b_s[l], w_conv[l], b_conv[l],
              w_a[l], b_a[l], w_x[l], b_x[l], lru_lambda[l])
        mk_p, mv_p = mem_kv(mem_prompt, g_mem[l], w_mk[l], w_mv[l])
        xp, _, conv_p, h_p = mixer_layer(xp, mk_p, mv_p, zero_buf, zero_h, *lp)
        xs, v_s, conv_s, h_s = mixer_layer(xs, cache_mem_k[l], cache_mem_v[l], state_conv[l], state_h[l], *lp)
        mk_p_all.append(mk_p); mv_p_all.append(mv_p); conv_p_all.append(conv_p); h_p_all.append(h_p)
        conv_s_all.append(conv_s); h_s_all.append(h_s); v_s_all.append(v_s)
    return (xp, xs, jnp.stack(mk_p_all), jnp.stack(mv_p_all), jnp.stack(conv_p_all), jnp.stack(h_p_all),
            jnp.stack(conv_s_all), jnp.stack(h_s_all), jnp.stack(v_s_all))
```

```cpp
#include <hip/hip_runtime.h>
#include <cstdint>
#include <cstdio>

namespace nv {
constexpr int D = 1024, NB = 8, SEQ = 2048, DEPTH = 2, SB = 128;
constexpr int AW = 384, AH = 4, AD = 96, CHUNK = 128, BW = 384, BK = 8, BD = 48, CW = 256, CH = 4, CD = 64, NMEM = 256;
constexpr int INW = 2432;
constexpr int OFF_U = 0, OFF_V = 384, OFF_GA = 768, OFF_XB = 1152, OFF_GB = 1536, OFF_Q = 1920, OFF_GC = 2176;
constexpr float EPS = 1e-6f;

__global__ void k_rmsnorm(const float* __restrict__ x, const float* __restrict__ g, float* __restrict__ out) {
    __shared__ float red[4];
    const int row = blockIdx.x, tid = threadIdx.x;
    const float4 v = ((const float4*)(x + (size_t)row * D))[tid];
    float s = v.x * v.x + v.y * v.y + v.z * v.z + v.w * v.w;
    for (int o = 32; o > 0; o >>= 1) s += __shfl_xor(s, o);
    if ((tid & 63) == 0) red[tid >> 6] = s;
    __syncthreads();
    const float tot = red[0] + red[1] + red[2] + red[3];
    const float rs = 1.0f / sqrtf(tot * (1.0f / D) + EPS);
    const float4 gg = ((const float4*)g)[tid];
    float4 o4; o4.x = v.x * rs * gg.x; o4.y = v.y * rs * gg.y; o4.z = v.z * rs * gg.z; o4.w = v.w * rs * gg.w;
    ((float4*)(out + (size_t)row * D))[tid] = o4;
}
__global__ void k_postnorm_res(const float* __restrict__ o, const float* __restrict__ g, const float* base, float* y) {
    __shared__ float red[4];
    const int row = blockIdx.x, tid = threadIdx.x;
    const float4 v = ((const float4*)(o + (size_t)row * D))[tid];
    float s = v.x * v.x + v.y * v.y + v.z * v.z + v.w * v.w;
    for (int of = 32; of > 0; of >>= 1) s += __shfl_xor(s, of);
    if ((tid & 63) == 0) red[tid >> 6] = s;
    __syncthreads();
    const float tot = red[0] + red[1] + red[2] + red[3];
    const float rs = 1.0f / sqrtf(tot * (1.0f / D) + EPS);
    const float4 gg = ((const float4*)g)[tid];
    const float4 b = ((const float4*)(base + (size_t)row * D))[tid];
    float4 o4; o4.x = b.x + v.x * rs * gg.x; o4.y = b.y + v.y * rs * gg.y; o4.z = b.z + v.z * rs * gg.z; o4.w = b.w + v.w * rs * gg.w;
    ((float4*)(y + (size_t)row * D))[tid] = o4;
}
__global__ void __launch_bounds__(256) k_gemm(const float* __restrict__ A, const float* __restrict__ B, float* __restrict__ C, int M, int N, int K) {
    __shared__ float As[16][64 + 4];
    __shared__ float Bs[16][64 + 4];
    const int tid = threadIdx.x, tx = tid & 15, ty = tid >> 4;
    const int m0 = blockIdx.y * 64, n0 = blockIdx.x * 64;
    float acc[4][4];
#pragma unroll
    for (int i = 0; i < 4; ++i)
#pragma unroll
        for (int j = 0; j < 4; ++j) acc[i][j] = 0.f;
    for (int k0 = 0; k0 < K; k0 += 16) {
        {
            const int r = tid >> 2, kq = (tid & 3) * 4;
            const float4 a = *(const float4*)(A + (size_t)(m0 + r) * K + k0 + kq);
            As[kq + 0][r] = a.x; As[kq + 1][r] = a.y; As[kq + 2][r] = a.z; As[kq + 3][r] = a.w;
            const int kr = tid >> 4, nq = (tid & 15) * 4;
            const float4 b = *(const float4*)(B + (size_t)(k0 + kr) * N + n0 + nq);
            Bs[kr][nq + 0] = b.x; Bs[kr][nq + 1] = b.y; Bs[kr][nq + 2] = b.z; Bs[kr][nq + 3] = b.w;
        }
        __syncthreads();
#pragma unroll
        for (int kk = 0; kk < 16; ++kk) {
            float a[4], b[4];
#pragma unroll
            for (int i = 0; i < 4; ++i) a[i] = As[kk][ty * 4 + i];
#pragma unroll
            for (int j = 0; j < 4; ++j) b[j] = Bs[kk][tx * 4 + j];
#pragma unroll
            for (int i = 0; i < 4; ++i)
#pragma unroll
                for (int j = 0; j < 4; ++j) acc[i][j] = fmaf(a[i], b[j], acc[i][j]);
        }
        __syncthreads();
    }
#pragma unroll
    for (int i = 0; i < 4; ++i) {
        float4 o; o.x = acc[i][0]; o.y = acc[i][1]; o.z = acc[i][2]; o.w = acc[i][3];
        *(float4*)(C + (size_t)(m0 + ty * 4 + i) * N + n0 + tx * 4) = o;
    }
}
__device__ __forceinline__ float sigmoidf_(float x) { return 1.0f / (1.0f + expf(-x)); }
__device__ __forceinline__ float siluf_(float x) { return x / (1.0f + expf(-x)); }

__global__ void __launch_bounds__(128) k_mixA(const float* __restrict__ z, int T, const float* __restrict__ g_v, const float* __restrict__ w_s, const float* __restrict__ b_s,
                                              float* __restrict__ mix, float* __restrict__ vn_out  ) {
    __shared__ float vn[CHUNK][AD + 1];
    const int h = blockIdx.x, c = blockIdx.y, n = blockIdx.z, i = threadIdx.x;
    const int t = c * CHUNK + i;
    const bool valid = t < T;
    const size_t row = (size_t)n * T + t;
    if (valid) {
        const float* v = z + row * INW + OFF_V + h * AD;
        float s = 0.f;
        for (int d = 0; d < AD; ++d) s += v[d] * v[d];
        const float rs = 1.0f / sqrtf(s * (1.0f / AD) + EPS);
        for (int d = 0; d < AD; ++d) { const float x = v[d] * rs * g_v[h * AD + d]; vn[i][d] = x; if (vn_out) vn_out[row * AW + h * AD + d] = x; }
    } else {
        for (int d = 0; d < AD; ++d) vn[i][d] = 0.f;
    }
    __syncthreads();
    if (!valid) return;
    const float* wrow = w_s + ((size_t)h * CHUNK + i) * CHUNK;
    const float bias = b_s[h * CHUNK + i];
    const float* u = z + row * INW + OFF_U + h * AD;
    const float* ga = z + row * INW + OFF_GA + h * AD;
    for (int d0 = 0; d0 < AD; d0 += 8) {
        float acc[8];
#pragma unroll
        for (int q = 0; q < 8; ++q) acc[q] = 0.f;
        for (int j = 0; j <= i; ++j) {
            const float w = wrow[j];
#pragma unroll
            for (int q = 0; q < 8; ++q) acc[q] = fmaf(w, vn[j][d0 + q], acc[q]);
        }
#pragma unroll
        for (int q = 0; q < 8; ++q) mix[row * D + h * AD + d0 + q] = u[d0 + q] * (acc[q] + bias) * siluf_(ga[d0 + q]);
    }
}
__global__ void __launch_bounds__(64) k_mixB(const float* __restrict__ z, int T, const float* __restrict__ conv0  , const float* __restrict__ h0  ,
                                             const float* __restrict__ w_conv, const float* __restrict__ b_conv, const float* __restrict__ w_a, const float* __restrict__ b_a,
                                             const float* __restrict__ w_x, const float* __restrict__ b_x, const float* __restrict__ lam,
                                             float* __restrict__ mix, float* __restrict__ conv_out  , float* __restrict__ h_out  ) {
    __shared__ float xcs[BD];
    const int k = blockIdx.x, n = blockIdx.y, j = threadIdx.x;
    const bool act = j < BD;
    const int ch = k * BD + (act ? j : 0);
    float wa[BD], wx[BD];
#pragma unroll
    for (int i = 0; i < BD; ++i) { wa[i] = w_a[((size_t)k * BD + i) * BD + (act ? j : 0)]; wx[i] = w_x[((size_t)k * BD + i) * BD + (act ? j : 0)]; }
    const float wc0 = w_conv[0 * BW + ch], wc1 = w_conv[1 * BW + ch], wc2 = w_conv[2 * BW + ch], wc3 = w_conv[3 * BW + ch], bc = b_conv[ch];
    const float ba = b_a[ch], bx = b_x[ch];
    const float sp = log1pf(expf(-lam[ch]));
    float xm3 = conv0 ? conv0[((size_t)n * 3 + 0) * BW + ch] : 0.f, xm2 = conv0 ? conv0[((size_t)n * 3 + 1) * BW + ch] : 0.f, xm1 = conv0 ? conv0[((size_t)n * 3 + 2) * BW + ch] : 0.f;
    float h = h0 ? h0[(size_t)n * BW + ch] : 0.f;
    for (int t = 0; t < T; ++t) {
        const size_t row = (size_t)n * T + t;
        const float x = z[row * INW + OFF_XB + ch];
        const float xc = bc + wc0 * xm3 + wc1 * xm2 + wc2 * xm1 + wc3 * x;
        xm3 = xm2; xm2 = xm1; xm1 = x;
        if (act) xcs[j] = xc;
        __syncthreads();
        float ra = ba, ri = bx;
#pragma unroll
        for (int i = 0; i < BD; ++i) { const float xi = xcs[i]; ra = fmaf(xi, wa[i], ra); ri = fmaf(xi, wx[i], ri); }
        const float r = sigmoidf_(ra), ig = sigmoidf_(ri);
        const float log_a = -8.0f * r * sp;
        const float a = expf(log_a);
        const float inp = sqrtf(-expm1f(2.0f * log_a)) * (ig * xc);
        h = a * h + inp;
        if (act) mix[row * D + AW + ch] = h * siluf_(z[row * INW + OFF_GB + ch]);
        __syncthreads();
    }
    if (act) {
        conv_out[((size_t)n * 3 + 0) * BW + ch] = xm3; conv_out[((size_t)n * 3 + 1) * BW + ch] = xm2; conv_out[((size_t)n * 3 + 2) * BW + ch] = xm1;
        h_out[(size_t)n * BW + ch] = h;
    }
}
__global__ void __launch_bounds__(256) k_mixC(const float* __restrict__ z, int T, const float* __restrict__ mk, const float* __restrict__ mv  , float* __restrict__ mix) {
    __shared__ float qs[CW];
    __shared__ float ps[CH][NMEM];
    __shared__ float red[CH][64];
    const int t = blockIdx.x, n = blockIdx.y, tid = threadIdx.x, h = tid >> 6, l = tid & 63;
    const size_t row = (size_t)n * T + t;
    qs[tid] = z[row * INW + OFF_Q + tid];
    __syncthreads();
    float sc[4]; float mx = -INFINITY;
#pragma unroll
    for (int q = 0; q < 4; ++q) {
        const int key = l + 64 * q;
        const float* kp = mk + (((size_t)n * NMEM + key) * CH + h) * CD;
        float s = 0.f;
        for (int d = 0; d < CD; ++d) s = fmaf(qs[h * CD + d], kp[d], s);
        sc[q] = s * 0.125f; mx = fmaxf(mx, sc[q]);
    }
    for (int o = 32; o > 0; o >>= 1) mx = fmaxf(mx, __shfl_xor(mx, o));
    float sum = 0.f;
#pragma unroll
    for (int q = 0; q < 4; ++q) { sc[q] = expf(sc[q] - mx); sum += sc[q]; }
    for (int o = 32; o > 0; o >>= 1) sum += __shfl_xor(sum, o);
    const float inv = 1.0f / sum;
#pragma unroll
    for (int q = 0; q < 4; ++q) ps[h][l + 64 * q] = sc[q] * inv;
    __syncthreads();
    float o = 0.f;
    for (int key = 0; key < NMEM; ++key) o = fmaf(ps[h][key], mv[(((size_t)n * NMEM + key) * CH + h) * CD + l], o);
    (void)red;
    mix[row * D + AW + BW + tid] = o * siluf_(z[row * INW + OFF_GC + tid]);
}

struct LayerW { const float *g_pre, *g_post, *w_in, *w_out, *g_v, *w_s, *b_s, *w_conv, *b_conv, *w_a, *b_a, *w_x, *b_x, *lam; };

static void mixer_layer(hipStream_t st, const float* x, float* y, int n, int T, const float* mk, const float* mv, const float* conv0, const float* h0, const LayerW& w,
                        float* hbuf, float* zbuf, float* vn_out, float* conv_out, float* h_out) {
    const int rows = n * T;
    k_rmsnorm<<<rows, 256, 0, st>>>(x, w.g_pre, hbuf);
    k_gemm<<<dim3(INW / 64, rows / 64), 256, 0, st>>>(hbuf, w.w_in, zbuf, rows, INW, D);
    float* mix = hbuf;
    k_mixA<<<dim3(AH, (T + CHUNK - 1) / CHUNK, n), 128, 0, st>>>(zbuf, T, w.g_v, w.w_s, w.b_s, mix, vn_out);
    k_mixB<<<dim3(BK, n), 64, 0, st>>>(zbuf, T, conv0, h0, w.w_conv, w.b_conv, w.w_a, w.b_a, w.w_x, w.b_x, w.lam, mix, conv_out, h_out);
    k_mixC<<<dim3(T, n), 256, 0, st>>>(zbuf, T, mk, mv, mix);
    float* o = zbuf;
    k_gemm<<<dim3(D / 64, rows / 64), 256, 0, st>>>(mix, w.w_out, o, rows, D, D);
    k_postnorm_res<<<rows, 256, 0, st>>>(o, w.g_post, x, y);
}
}

extern "C" void kernel_launch(void* const* d_in, const int* in_sizes, int n_in, void* d_out, int out_size, void* d_ws, size_t ws_size, hipStream_t stream) {
    using namespace nv;
    const float* x_prompt = (const float*)d_in[0]; const float* x_sample = (const float*)d_in[1]; const float* mem_prompt = (const float*)d_in[2];
    const float* cache_k = (const float*)d_in[3]; const float* cache_v = (const float*)d_in[4]; const float* state_conv = (const float*)d_in[5]; const float* state_h = (const float*)d_in[6];
    const float* g_pre = (const float*)d_in[7]; const float* g_post = (const float*)d_in[8]; const float* w_in = (const float*)d_in[9]; const float* w_out = (const float*)d_in[10];
    const float* g_v = (const float*)d_in[11]; const float* w_s = (const float*)d_in[12]; const float* b_s = (const float*)d_in[13]; const float* w_conv = (const float*)d_in[14];
    const float* b_conv = (const float*)d_in[15]; const float* w_a = (const float*)d_in[16]; const float* b_a = (const float*)d_in[17]; const float* w_x = (const float*)d_in[18];
    const float* b_x = (const float*)d_in[19]; const float* lam = (const float*)d_in[20]; const float* g_mem = (const float*)d_in[21]; const float* w_mk = (const float*)d_in[22]; const float* w_mv = (const float*)d_in[23];
    float* out = (float*)d_out;
    const size_t MP = (size_t)NB * SEQ;
    float* y_prompt = out; float* y_sample = out + MP * D;
    float* o_mk = y_sample + (size_t)SB * D; float* o_mv = o_mk + (size_t)DEPTH * NB * NMEM * CW;
    float* o_convp = o_mv + (size_t)DEPTH * NB * NMEM * CW; float* o_hp = o_convp + (size_t)DEPTH * NB * 3 * BW;
    float* o_convs = o_hp + (size_t)DEPTH * NB * BW; float* o_hs = o_convs + (size_t)DEPTH * SB * 3 * BW; float* o_vs = o_hs + (size_t)DEPTH * SB * BW;
    char* ws = (char*)d_ws;
    float* hbuf = (float*)ws;
    float* zbuf = (float*)(ws + (size_t)64 * 1024 * 1024);
    float* mnbuf = (float*)(ws + (size_t)216 * 1024 * 1024);
    float* shbuf = (float*)(ws + (size_t)224 * 1024 * 1024);
    float* szbuf = (float*)(ws + (size_t)225 * 1024 * 1024);
    for (int l = 0; l < DEPTH; ++l) {
        LayerW w{g_pre + (size_t)l * D, g_post + (size_t)l * D, w_in + (size_t)l * D * INW, w_out + (size_t)l * D * D, g_v + (size_t)l * AW, w_s + (size_t)l * AH * CHUNK * CHUNK, b_s + (size_t)l * AH * CHUNK,
                 w_conv + (size_t)l * 4 * BW, b_conv + (size_t)l * BW, w_a + (size_t)l * BK * BD * BD, b_a + (size_t)l * BW, w_x + (size_t)l * BK * BD * BD, b_x + (size_t)l * BW, lam + (size_t)l * BW};
        float* mk_p = o_mk + (size_t)l * NB * NMEM * CW; float* mv_p = o_mv + (size_t)l * NB * NMEM * CW;
        k_rmsnorm<<<NB * NMEM, 256, 0, stream>>>(mem_prompt, g_mem + (size_t)l * D, mnbuf);
        k_gemm<<<dim3(CW / 64, NB * NMEM / 64), 256, 0, stream>>>(mnbuf, w_mk + (size_t)l * D * CW, mk_p, NB * NMEM, CW, D);
        k_gemm<<<dim3(CW / 64, NB * NMEM / 64), 256, 0, stream>>>(mnbuf, w_mv + (size_t)l * D * CW, mv_p, NB * NMEM, CW, D);
        mixer_layer(stream, l == 0 ? x_prompt : y_prompt, y_prompt, NB, SEQ, mk_p, mv_p, nullptr, nullptr, w, hbuf, zbuf, nullptr,
                    o_convp + (size_t)l * NB * 3 * BW, o_hp + (size_t)l * NB * BW);
        mixer_layer(stream, l == 0 ? x_sample : y_sample, y_sample, SB, 1, cache_k + (size_t)l * SB * NMEM * CW, cache_v + (size_t)l * SB * NMEM * CW,
                    state_conv + (size_t)l * SB * 3 * BW, state_h + (size_t)l * SB * BW, w, shbuf, szbuf, o_vs + (size_t)l * SB * AW,
                    o_convs + (size_t)l * SB * 3 * BW, o_hs + (size_t)l * SB * BW);
    }
}
```
